# Optimizing an MI355X kernel written in HIP

```python
import math
import jax
import jax.numpy as jnp
from jax import lax
import numpy as np

D_MODEL = 1024
BATCH = 8
SEQ = 4096
DEPTH = 1
DEC_BATCH = 2
DEC_SEQ = 8192
PAST_LEN = 128

D_RNN = 1280
N_LRU_BLOCKS = 8
LRU_BLOCK = D_RNN // N_LRU_BLOCKS
LRU_C = 8.0
LRU_CONV_W = 4
LRU_CONV_PAD = (2, 1)
HEAD_DIM = 128
N_HEADS = D_MODEL // HEAD_DIM
N_KV_HEADS = 2
GROUP = N_HEADS // N_KV_HEADS
WINDOW = 128
BLOCK = 128
N_BUCKETS = 32
MAX_DISTANCE = 128
Q_DIM = N_HEADS * HEAD_DIM
KV_DIM = N_KV_HEADS * HEAD_DIM
D_FF = 3 * D_MODEL
FFN_CONV_W = 3
FFN_CONV_PAD = (1, 1)
ALPHA = (2.0 * DEPTH) ** 0.25
BETA = (8.0 * DEPTH) ** -0.25
LN_EPS = 1e-5
NEG_INF = -1e30

SPLIT_SIZES = (D_RNN, D_RNN, Q_DIM, KV_DIM, KV_DIM, D_MODEL, D_MODEL)
SPLIT_IDX = tuple(sum(SPLIT_SIZES[:i + 1]) for i in range(len(SPLIT_SIZES) - 1))
D_IN = sum(SPLIT_SIZES)
V_OFF = 2 * D_RNN + Q_DIM + KV_DIM

kernel_name = "hybrid_rglru_swa_encoder"


def layer_norm(x, g, b):
    xf = x.astype(jnp.float32)
    mu = jnp.mean(xf, axis=-1, keepdims=True)
    var = jnp.mean(jnp.square(xf - mu), axis=-1, keepdims=True)
    y = (xf - mu) * lax.rsqrt(var + LN_EPS) * g.astype(jnp.float32) + b.astype(jnp.float32)
    return y.astype(x.dtype)


def depthwise_conv(x, w, b, pad):
    s = x.shape[1]
    xp = jnp.pad(x, ((0, 0), pad, (0, 0)))
    out = b
    for tap in range(w.shape[0]):
        out = out + w[tap] * xp[:, tap:tap + s]
    return out


def block_diag_linear(x, w, b):
    xb = x.reshape(x.shape[0], x.shape[1], N_LRU_BLOCKS, LRU_BLOCK)
    y = jnp.einsum('bsni,nij->bsnj', xb, w) + b
    return y.reshape(x.shape)


def _linear_recurrence_combine(left, right):
    a1, b1 = left
    a2, b2 = right
    return a1 * a2, a2 * b1 + b2


def rg_lru_scan(u, w_a, b_a, w_x, b_x, lam):
    r = jax.nn.sigmoid(block_diag_linear(u, w_a, b_a).astype(jnp.float32))
    i = jax.nn.sigmoid(block_diag_linear(u, w_x, b_x).astype(jnp.float32))
    log_a = LRU_C * r * jax.nn.log_sigmoid(lam.astype(jnp.float32))
    a = jnp.exp(log_a)
    bt = jnp.sqrt(-jnp.expm1(2.0 * log_a)) * (i * u.astype(jnp.float32))
    _, h = lax.associative_scan(_linear_recurrence_combine, (a, bt), axis=1)
    return h


def t5_bucket(rel):
    nb = N_BUCKETS // 2
    ret = jnp.where(rel > 0, nb, 0)
    n = jnp.abs(rel)
    max_exact = nb // 2
    nf = jnp.maximum(n, 1).astype(jnp.float32)
    large = max_exact + (jnp.log(nf / max_exact) / math.log(MAX_DISTANCE / max_exact)
                         * (nb - max_exact)).astype(jnp.int32)
    large = jnp.minimum(large, nb - 1)
    return ret + jnp.where(n < max_exact, n, large)


def band_bias_and_mask(rel_table, seq_len):
    nblk = seq_len // BLOCK
    q_off = jnp.arange(BLOCK)[:, None]
    c_off = jnp.arange(3 * BLOCK)[None, :]
    rel = c_off - BLOCK - q_off
    bias = rel_table.astype(jnp.float32)[t5_bucket(rel)]
    bias = bias.transpose(2, 0, 1).reshape(N_KV_HEADS, GROUP, BLOCK, 3 * BLOCK)
    key_pos = jnp.arange(nblk)[:, None] * BLOCK + jnp.arange(3 * BLOCK)[None, :] - BLOCK
    in_range = (key_pos >= 0) & (key_pos < seq_len)
    mask = (jnp.abs(rel) <= WINDOW)[None] & in_range[:, None, :]
    return bias, mask


def windowed_gqa(q, k, v, rel_table, sink):
    bsz, s = q.shape[0], q.shape[1]
    nblk = s // BLOCK
    qb = q.reshape(bsz, nblk, BLOCK, N_KV_HEADS, GROUP, HEAD_DIM)

    def band(t):
        tp = jnp.pad(t, ((0, 0), (BLOCK, BLOCK), (0, 0), (0, 0)))
        tp = tp.reshape(bsz, nblk + 2, BLOCK, N_KV_HEADS, HEAD_DIM)
        return jnp.concatenate([tp[:, :-2], tp[:, 1:-1], tp[:, 2:]], axis=2)

    kb, vb = band(k), band(v)
    bias, mask = band_bias_and_mask(rel_table, s)
    scores = jnp.einsum('bnqhgd,bnchd->bnhgqc', qb, kb,
                        preferred_element_type=jnp.float32) * (HEAD_DIM ** -0.5)
    scores = jnp.where(mask[None, :, None, None], scores + bias[None, None], NEG_INF)
    sink_l = sink.astype(jnp.float32).reshape(N_KV_HEADS, GROUP, 1, 1)
    m = jnp.maximum(jnp.max(scores, axis=-1, keepdims=True), sink_l)
    p = jnp.exp(scores - m)
    denom = jnp.sum(p, axis=-1, keepdims=True) + jnp.exp(sink_l - m)
    probs = (p / denom).astype(vb.dtype)
    out = jnp.einsum('bnhgqc,bnchd->bnqhgd', probs, vb)
    return out.reshape(bsz, s, Q_DIM)


def encoder_layer(x, rel_table, w_in, b_in, w_lru_conv, b_lru_conv, w_rg_a, b_rg_a, w_rg_x, b_rg_x,
                  lru_lambda, w_lru_out, attn_sink, w_attn_out, w_o, b_o, ln1_g, ln1_b,
                  w_up, b_up, w_ffn_conv, b_ffn_conv, w_down, b_down, ln2_g, ln2_b):
    bsz, s, _ = x.shape
    proj = x @ w_in + b_in
    u_lru, g_lru, q, k, v, gate_lru, gate_attn = jnp.split(proj, SPLIT_IDX, axis=-1)

    u = depthwise_conv(u_lru, w_lru_conv, b_lru_conv, LRU_CONV_PAD)
    h_fwd = rg_lru_scan(u, w_rg_a[0], b_rg_a[0], w_rg_x[0], b_rg_x[0], lru_lambda[0])
    h_bwd = jnp.flip(rg_lru_scan(jnp.flip(u, axis=1), w_rg_a[1], b_rg_a[1], w_rg_x[1], b_rg_x[1],
                                 lru_lambda[1]), axis=1)
    y_lru = ((h_fwd + h_bwd).astype(x.dtype) * jax.nn.gelu(g_lru)) @ w_lru_out

    attn = windowed_gqa(q.reshape(bsz, s, N_HEADS, HEAD_DIM),
                        k.reshape(bsz, s, N_KV_HEADS, HEAD_DIM),
                        v.reshape(bsz, s, N_KV_HEADS, HEAD_DIM), rel_table, attn_sink)
    y_attn = attn @ w_attn_out

    mix = (jax.nn.sigmoid(gate_lru) * y_lru + jax.nn.sigmoid(gate_attn) * y_attn) @ w_o + b_o
    x = layer_norm(ALPHA * x + mix, ln1_g, ln1_b)

    hu = depthwise_conv(x @ w_up + b_up, w_ffn_conv, b_ffn_conv, FFN_CONV_PAD)
    val, gt = jnp.split(hu, 2, axis=-1)
    ffn = (jax.nn.gelu(gt) * val) @ w_down + b_down
    return layer_norm(ALPHA * x + ffn, ln2_g, ln2_b)


def setup_inputs(seed: int = 0) -> dict:
    key = jax.random.key(seed)
    ks = jax.random.split(key, 32)
    f32 = jnp.float32

    def nrm(k, shape, scale):
        return jax.random.normal(k, shape, f32) * scale

    v_col_scale = jnp.ones((D_IN,), f32).at[V_OFF:V_OFF + KV_DIM].set(BETA)
    u = jax.random.uniform(ks[10], (DEPTH, 2, D_RNN), f32, 0.9, 0.999)
    a_base = u ** (1.0 / LRU_C)
    lru_lambda = jnp.log(a_base) - jnp.log1p(-a_base)
    return {
        'x_prompt': nrm(ks[0], (BATCH, SEQ, D_MODEL), 1.0),
        'x_sample': nrm(ks[1], (DEC_BATCH, DEC_SEQ, D_MODEL), 1.0),
        'rel_table': nrm(ks[2], (N_BUCKETS, N_HEADS), 0.5),
        'w_in': nrm(ks[3], (DEPTH, D_MODEL, D_IN), D_MODEL ** -0.5) * v_col_scale,
        'b_in': nrm(ks[4], (DEPTH, D_IN), 0.01),
        'w_lru_conv': nrm(ks[5], (DEPTH, LRU_CONV_W, D_RNN), LRU_CONV_W ** -0.5),
        'b_lru_conv': nrm(ks[6], (DEPTH, D_RNN), 0.01),
        'w_rg_a': nrm(ks[7], (DEPTH, 2, N_LRU_BLOCKS, LRU_BLOCK, LRU_BLOCK), LRU_BLOCK ** -0.5),
        'b_rg_a': nrm(ks[8], (DEPTH, 2, N_LRU_BLOCKS, LRU_BLOCK), 0.01),
        'w_rg_x': nrm(ks[9], (DEPTH, 2, N_LRU_BLOCKS, LRU_BLOCK, LRU_BLOCK), LRU_BLOCK ** -0.5),
        'b_rg_x': nrm(ks[11], (DEPTH, 2, N_LRU_BLOCKS, LRU_BLOCK), 0.01),
        'lru_lambda': lru_lambda,
        'w_lru_out': nrm(ks[12], (DEPTH, D_RNN, D_MODEL), BETA * D_RNN ** -0.5),
        'attn_sink': nrm(ks[13], (DEPTH, N_HEADS), 0.5),
        'w_attn_out': nrm(ks[14], (DEPTH, Q_DIM, D_MODEL), BETA * Q_DIM ** -0.5),
        'w_o': nrm(ks[15], (DEPTH, D_MODEL, D_MODEL), BETA * D_MODEL ** -0.5),
        'b_o': nrm(ks[16], (DEPTH, D_MODEL), 0.01),
        'ln1_g': 1.0 + nrm(ks[17], (DEPTH, D_MODEL), 0.02),
        'ln1_b': nrm(ks[18], (DEPTH, D_MODEL), 0.01),
        'w_up': nrm(ks[19], (DEPTH, D_MODEL, 2 * D_FF), D_MODEL ** -0.5),
        'b_up': nrm(ks[20], (DEPTH, 2 * D_FF), 0.01),
        'w_ffn_conv': nrm(ks[21], (DEPTH, FFN_CONV_W, 2 * D_FF), FFN_CONV_W ** -0.5),
        'b_ffn_conv': nrm(ks[22], (DEPTH, 2 * D_FF), 0.01),
        'w_down': nrm(ks[23], (DEPTH, D_FF, D_MODEL), BETA * D_FF ** -0.5),
        'b_down': nrm(ks[24], (DEPTH, D_MODEL), 0.01),
        'ln2_g': 1.0 + nrm(ks[25], (DEPTH, D_MODEL), 0.02),
        'ln2_b': nrm(ks[26], (DEPTH, D_MODEL), 0.01),
    }


def reference(x_prompt, x_sample, rel_table, w_in, b_in, w_lru_conv, b_lru_conv, w_rg_a, b_rg_a,
              w_rg_x, b_rg_x, lru_lambda, w_lru_out, attn_sink, w_attn_out, w_o, b_o, ln1_g, ln1_b,
              w_up, b_up, w_ffn_conv, b_ffn_conv, w_down, b_down, ln2_g, ln2_b):
    y_prompt = x_prompt
    y_sample = x_sample
    for l in range(DEPTH):
        p = (w_in[l], b_in[l], w_lru_conv[l], b_lru_conv[l], w_rg_a[l], b_rg_a[l], w_rg_x[l], b_rg_x[l],
             lru_lambda[l], w_lru_out[l], attn_sink[l], w_attn_out[l], w_o[l], b_o[l], ln1_g[l], ln1_b[l],
             w_up[l], b_up[l], w_ffn_conv[l], b_ffn_conv[l], w_down[l], b_down[l], ln2_g[l], ln2_b[l])
        y_prompt = encoder_layer(y_prompt, rel_table, *p)
        y_sample = encoder_layer(y_sample, rel_table, *p)
    return (y_prompt, y_sample)
```

```cpp
#include <hip/hip_runtime.h>
#include <cstdio>
#include <cstdint>

typedef unsigned short bf16;
constexpr int D = 1024, DIN = 6144, DRNN = 1280, LBK = 160, NHEAD = 8, HD = 128, DFF = 3072, DUP = 6144;
constexpr int MG = 16384;
constexpr int NG = 3;
constexpr int CH = 128, NCH = MG / CH;
constexpr float ALPHA = 1.189207115002721f;
constexpr float LN_EPS = 1e-5f;
constexpr float LOG2E = 1.4426950408889634f;
constexpr float QSCALE = 0.08838834764831845f * LOG2E;
constexpr float NEG_BIG = -1e30f;
constexpr size_t MiB = 1u << 20;
constexpr size_t WS_CTL = 0;
constexpr size_t WS_WIN = 2 * MiB, WS_WUP = 14 * MiB, WS_WD = 26 * MiB, WS_WLA = 32 * MiB, WS_WO = 37 * MiB, WS_RGW = 39 * MiB;
constexpr size_t WS_TAB = 41 * MiB;
constexpr size_t TAB_C8 = 0, TAB_BIAS2 = 16384, TAB_SINK2 = 16384 + 32768;
constexpr size_t WS_SUM = 42 * MiB;
constexpr size_t WS_HIN = 46 * MiB;
constexpr size_t WS_A = 52 * MiB, WS_B = 244 * MiB, WS_C = 364 * MiB, WS_END = 436 * MiB;
constexpr size_t A_U = 0, A_GG = 40 * MiB, A_Q = 80 * MiB, A_K = 112 * MiB, A_VT = 120 * MiB, A_SGL = 128 * MiB, A_SGA = 160 * MiB;
constexpr size_t B_S = 0, B_PF = 40 * MiB, B_PB = 80 * MiB, B_Z = 0, B_X1B = 32 * MiB, B_H = 0;

__host__ __device__ __forceinline__ unsigned f2bf_bits(float f) { unsigned u = __builtin_bit_cast(unsigned, f); return (u + 0x7fffu + ((u >> 16) & 1u)) >> 16; }
__device__ __forceinline__ bf16 f2bf(float f) { return (bf16)f2bf_bits(f); }
__device__ __forceinline__ float bf2f(bf16 b) { return __builtin_bit_cast(float, (unsigned)b << 16); }
__device__ __forceinline__ float sigmoidf_(float x) { return 1.0f / (1.0f + __expf(-x)); }
__device__ __forceinline__ float gelu_tanh(float x) { const float u = 1.5957691216057308f * x * (1.0f + 0.044715f * x * x); return x / (1.0f + __expf(-u)); }
__host__ __device__ __forceinline__ int t5_bucket(int rel) {
    const int n = rel < 0 ? -rel : rel; const int ret = rel > 0 ? 16 : 0;
    if (n < 8) return ret + n;
    int l = 8 + (n >= 12) + (n >= 16) + (n >= 23) + (n >= 32) + (n >= 46) + (n >= 64) + (n >= 91);
    return ret + (l > 15 ? 15 : l);
}

namespace nv {
__global__ void cvt_x(const float* __restrict__ x, bf16* __restrict__ xb, size_t n4) {
    size_t i = (size_t)blockIdx.x * blockDim.x + threadIdx.x; const size_t st = (size_t)gridDim.x * blockDim.x;
    for (; i < n4; i += st) { const float4 v = ((const float4*)x)[i]; uint2 o; o.x = f2bf_bits(v.x) | (f2bf_bits(v.y) << 16); o.y = f2bf_bits(v.z) | (f2bf_bits(v.w) << 16); ((uint2*)xb)[i] = o; }
}
__global__ void transpose_w(const float* __restrict__ W, int K, int N, bf16* __restrict__ WT, int ldt, int koff) {
    const size_t tot = (size_t)K * N; size_t i = (size_t)blockIdx.x * blockDim.x + threadIdx.x; const size_t st = (size_t)gridDim.x * blockDim.x;
    for (; i < tot; i += st) { const int k = (int)(i / N), n = (int)(i % N); WT[(size_t)n * ldt + koff + k] = f2bf(W[i]); }
}
__global__ void transpose_rg(const float* __restrict__ wa, const float* __restrict__ wx, bf16* __restrict__ RGW) {
    const int tot = 2 * 8 * 2 * 160 * 160; int i = blockIdx.x * blockDim.x + threadIdx.x;
    if (i >= tot) return;
    const int k = i % 160, n = (i / 160) % 160, mat = (i / 25600) % 2, db = i / 51200;
    const float* w = mat ? wx : wa; RGW[i] = f2bf(w[(size_t)db * 25600 + k * 160 + n]);
}
__global__ void tables(const float* __restrict__ lam, const float* __restrict__ rel_table, const float* __restrict__ sink, float* C8, float* BIAS2, float* SINK2) {
    const int i = blockIdx.x * blockDim.x + threadIdx.x;
    if (i < 2560) { const float l = lam[i]; const float ls = fminf(l, 0.f) - log1pf(expf(-fabsf(l))); C8[i] = 8.0f * ls; }
    if (i < 8 * 511) { const int h = i / 511, rel = i % 511 - 255; const int n = rel < 0 ? -rel : rel; BIAS2[i] = (n <= 128) ? rel_table[t5_bucket(rel) * 8 + h] * LOG2E : NEG_BIG; }
    if (i < 8) SINK2[i] = sink[i] * LOG2E;
}
template <class Epi>
__global__ void __launch_bounds__(256) gemm(const bf16* __restrict__ A, int lda, const bf16* __restrict__ Bt, int ldb, int K, Epi epi) {
    __shared__ float As[16][132], Bs[16][132];
    const int tx = threadIdx.x & 15, ty = threadIdx.x >> 4, row0 = blockIdx.y * 128, col0 = blockIdx.x * 128;
    float acc[8][8];
#pragma unroll
    for (int i = 0; i < 8; ++i)
#pragma unroll
        for (int j = 0; j < 8; ++j) acc[i][j] = 0.f;
    const int lr = threadIdx.x >> 1, lc = (threadIdx.x & 1) * 8;
    for (int k0 = 0; k0 < K; k0 += 16) {
        const uint4 av = *(const uint4*)(A + (size_t)(row0 + lr) * lda + k0 + lc), bv = *(const uint4*)(Bt + (size_t)(col0 + lr) * ldb + k0 + lc);
        As[lc + 0][lr] = bf2f((bf16)(av.x & 0xffffu)); As[lc + 1][lr] = bf2f((bf16)(av.x >> 16)); As[lc + 2][lr] = bf2f((bf16)(av.y & 0xffffu)); As[lc + 3][lr] = bf2f((bf16)(av.y >> 16));
        As[lc + 4][lr] = bf2f((bf16)(av.z & 0xffffu)); As[lc + 5][lr] = bf2f((bf16)(av.z >> 16)); As[lc + 6][lr] = bf2f((bf16)(av.w & 0xffffu)); As[lc + 7][lr] = bf2f((bf16)(av.w >> 16));
        Bs[lc + 0][lr] = bf2f((bf16)(bv.x & 0xffffu)); Bs[lc + 1][lr] = bf2f((bf16)(bv.x >> 16)); Bs[lc + 2][lr] = bf2f((bf16)(bv.y & 0xffffu)); Bs[lc + 3][lr] = bf2f((bf16)(bv.y >> 16));
        Bs[lc + 4][lr] = bf2f((bf16)(bv.z & 0xffffu)); Bs[lc + 5][lr] = bf2f((bf16)(bv.z >> 16)); Bs[lc + 6][lr] = bf2f((bf16)(bv.w & 0xffffu)); Bs[lc + 7][lr] = bf2f((bf16)(bv.w >> 16));
        __syncthreads();
#pragma unroll 4
        for (int kk = 0; kk < 16; ++kk) {
            const float4 a0 = *(const float4*)&As[kk][ty * 4], a1 = *(const float4*)&As[kk][64 + ty * 4], b0 = *(const float4*)&Bs[kk][tx * 4], b1 = *(const float4*)&Bs[kk][64 + tx * 4];
            const float a[8] = {a0.x, a0.y, a0.z, a0.w, a1.x, a1.y, a1.z, a1.w}, b[8] = {b0.x, b0.y, b0.z, b0.w, b1.x, b1.y, b1.z, b1.w};
#pragma unroll
            for (int i = 0; i < 8; ++i)
#pragma unroll
                for (int j = 0; j < 8; ++j) acc[i][j] += a[i] * b[j];
        }
        __syncthreads();
    }
#pragma unroll
    for (int i = 0; i < 8; ++i)
#pragma unroll
        for (int j = 0; j < 8; ++j) epi(row0 + (i < 4 ? ty * 4 + i : 64 + ty * 4 + i - 4), col0 + (j < 4 ? tx * 4 + j : 64 + tx * 4 + j - 4), acc[i][j]);
}
struct EpiProj { const float* bias; bf16 *U, *GG, *Q, *Kb, *Vt, *SGL, *SGA;
    __device__ void operator()(int m, int c, float acc) const {
        const float v = acc + bias[c];
        if (c < 1280) U[(size_t)m * 1280 + c] = f2bf(v);
        else if (c < 2560) GG[(size_t)m * 1280 + c - 1280] = f2bf(gelu_tanh(v));
        else if (c < 3584) Q[(size_t)m * 1024 + c - 2560] = f2bf(v * QSCALE);
        else if (c < 3840) Kb[(size_t)m * 256 + c - 3584] = f2bf(v);
        else if (c < 4096) Vt[(size_t)(c - 3840) * MG + m] = f2bf(v);
        else if (c < 5120) SGL[(size_t)m * 1024 + c - 4096] = f2bf(sigmoidf_(v));
        else SGA[(size_t)m * 1024 + c - 5120] = f2bf(sigmoidf_(v));
    } };
struct EpiZ1 { const bf16* SGL; bf16* Z; __device__ void operator()(int m, int c, float acc) const { const size_t o = (size_t)m * 1024 + c; Z[o] = f2bf(bf2f(SGL[o]) * acc); } };
struct EpiZ2 { const bf16* SGA; bf16* Z; __device__ void operator()(int m, int c, float acc) const { const size_t o = (size_t)m * 1024 + c; Z[o] = f2bf(bf2f(Z[o]) + bf2f(SGA[o]) * acc); } };
struct EpiRes { const float* base; const float* bias; float* out; __device__ void operator()(int m, int c, float acc) const { const size_t o = (size_t)m * 1024 + c; out[o] = ALPHA * base[o] + acc + bias[c]; } };
struct EpiUp { const float* bias; bf16* UP; __device__ void operator()(int m, int c, float acc) const { UP[(size_t)m * DUP + c] = f2bf(acc + bias[c]); } };

__global__ void __launch_bounds__(256) ln_rows(float* X, const float* __restrict__ g, const float* __restrict__ b, bf16* XB, int rows) {
    const int row = blockIdx.x * 4 + (threadIdx.x >> 6), lane = threadIdx.x & 63; if (row >= rows) return;
    float4* p = (float4*)(X + (size_t)row * 1024) + lane; float4 v[4]; float s = 0.f;
#pragma unroll
    for (int j = 0; j < 4; ++j) { v[j] = p[64 * j]; s += (v[j].x + v[j].y) + (v[j].z + v[j].w); }
#pragma unroll
    for (int o = 1; o < 64; o <<= 1) s += __shfl_xor(s, o);
    const float mean = s * (1.f / 1024.f); float q = 0.f;
#pragma unroll
    for (int j = 0; j < 4; ++j) { v[j].x -= mean; v[j].y -= mean; v[j].z -= mean; v[j].w -= mean; q += (v[j].x * v[j].x + v[j].y * v[j].y) + (v[j].z * v[j].z + v[j].w * v[j].w); }
#pragma unroll
    for (int o = 1; o < 64; o <<= 1) q += __shfl_xor(q, o);
    const float rstd = 1.0f / sqrtf(q * (1.f / 1024.f) + LN_EPS);
#pragma unroll
    for (int j = 0; j < 4; ++j) { const int c = (64 * j + lane) * 4; const float4 gg = *(const float4*)(g + c), bb = *(const float4*)(b + c);
        float4 o; o.x = v[j].x * rstd * gg.x + bb.x; o.y = v[j].y * rstd * gg.y + bb.y; o.z = v[j].z * rstd * gg.z + bb.z; o.w = v[j].w * rstd * gg.w + bb.w; p[64 * j] = o;
        if (XB) { uint2 w; w.x = f2bf_bits(o.x) | (f2bf_bits(o.y) << 16); w.y = f2bf_bits(o.z) | (f2bf_bits(o.w) << 16); *(uint2*)(XB + (size_t)row * 1024 + c) = w; } }
}
__global__ void lru_conv(const bf16* __restrict__ U, const float* __restrict__ w, const float* __restrict__ b, bf16* __restrict__ UC, int L) {
    const size_t i = (size_t)blockIdx.x * blockDim.x + threadIdx.x; if (i >= (size_t)MG * 1280) return;
    const int m = (int)(i / 1280), c = (int)(i % 1280), t = m % L; float acc = b[c];
#pragma unroll
    for (int j = 0; j < 4; ++j) { const int tt = t + j - 2; if (tt >= 0 && tt < L) acc += w[j * 1280 + c] * bf2f(U[(size_t)(m + j - 2) * 1280 + c]); }
    UC[i] = f2bf(acc);
}
__global__ void __launch_bounds__(128) lru_chunk(const bf16* __restrict__ UC, const bf16* __restrict__ RGW, const float* __restrict__ ba, const float* __restrict__ bx, const float* __restrict__ C8,
                                                 bf16* Sb, bf16* PF, bf16* PB, float* SUM) {
    const int idx = blockIdx.x * blockDim.x + threadIdx.x; if (idx >= NCH * 1280) return;
    const int chunk = idx / 1280, ch = idx % 1280, n = ch / 160, j = ch % 160, m0 = chunk * CH;
    for (int dir = 0; dir < 2; ++dir) {
        const bf16* wa = RGW + ((size_t)((dir * 8 + n) * 2 + 0) * 160 + j) * 160; const bf16* wx = RGW + ((size_t)((dir * 8 + n) * 2 + 1) * 160 + j) * 160;
        const float bias_a = ba[(dir * 8 + n) * 160 + j], bias_x = bx[(dir * 8 + n) * 160 + j], c8 = C8[dir * 1280 + ch];
        float h = 0.f, P = 1.f;
        for (int s = 0; s < CH; ++s) {
            const int m = m0 + (dir == 0 ? s : CH - 1 - s); const bf16* ur = UC + (size_t)m * 1280 + n * 160;
            float pa = bias_a, px = bias_x;
            for (int i = 0; i < 160; ++i) { const float u = bf2f(ur[i]); pa += u * bf2f(wa[i]); px += u * bf2f(wx[i]); }
            const float r = sigmoidf_(pa), ig = sigmoidf_(px), la = c8 * r, a = __expf(la), bt = sqrtf(fmaxf(0.f, 1.0f - __expf(2.0f * la))) * ig * bf2f(ur[j]);
            h = a * h + bt; P *= a;
            const size_t o = (size_t)m * 1280 + ch;
            if (dir == 0) { PF[o] = f2bf(P); Sb[o] = f2bf(h); } else { PB[o] = f2bf(P); Sb[o] = f2bf(bf2f(Sb[o]) + h); }
        }
        SUM[((size_t)chunk * 4 + dir * 2 + 0) * 1280 + ch] = P; SUM[((size_t)chunk * 4 + dir * 2 + 1) * 1280 + ch] = h;
    }
}
__global__ void lru_carry(const float* __restrict__ SUM, float* HIN, int nseq, int cps) {
    const int idx = blockIdx.x * blockDim.x + threadIdx.x; if (idx >= nseq * 1280 * 2) return;
    const int ch = idx % 1280, dir = (idx / 1280) % 2, sq = idx / 2560; float h = 0.f;
    for (int s = 0; s < cps; ++s) { const int c = sq * cps + (dir == 0 ? s : cps - 1 - s);
        HIN[((size_t)c * 2 + dir) * 1280 + ch] = h; h = SUM[((size_t)c * 4 + dir * 2) * 1280 + ch] * h + SUM[((size_t)c * 4 + dir * 2 + 1) * 1280 + ch]; }
}
__global__ void lru_final(const bf16* __restrict__ Sb, const bf16* __restrict__ PF, const bf16* __restrict__ PB, const float* __restrict__ HIN, const bf16* __restrict__ GG, bf16* HA) {
    const size_t i = (size_t)blockIdx.x * blockDim.x + threadIdx.x; if (i >= (size_t)MG * 1280) return;
    const int m = (int)(i / 1280), c = (int)(i % 1280), chunk = m / CH;
    const float h = bf2f(Sb[i]) + bf2f(PF[i]) * HIN[((size_t)chunk * 2 + 0) * 1280 + c] + bf2f(PB[i]) * HIN[((size_t)chunk * 2 + 1) * 1280 + c];
    HA[(size_t)m * 2304 + c] = f2bf(h * bf2f(GG[i]));
}
__global__ void __launch_bounds__(128) attn(const bf16* __restrict__ Q, const bf16* __restrict__ Kb, const bf16* __restrict__ Vt, const float* __restrict__ BIAS2, const float* __restrict__ SINK2, bf16* HA, int L) {
    __shared__ float qs[128], sc[264], red[4];
    const int m = blockIdx.x, h = blockIdx.y, kvh = h >> 2, tid = threadIdx.x, t = m % L, sbase = m - t;
    qs[tid] = bf2f(Q[(size_t)m * 1024 + h * 128 + tid]); __syncthreads();
    float mx = SINK2[h];
    for (int j = tid; j < 257; j += 128) { const int p = t - 128 + j; float s = NEG_BIG;
        if (p >= 0 && p < L) { const bf16* kr = Kb + (size_t)(sbase + p) * 256 + kvh * 128; float d = 0.f; for (int e = 0; e < 128; ++e) d += qs[e] * bf2f(kr[e]); s = d + BIAS2[h * 511 + (j - 128) + 255]; }
        sc[j] = s; mx = fmaxf(mx, s); }
#pragma unroll
    for (int o = 1; o < 64; o <<= 1) mx = fmaxf(mx, __shfl_xor(mx, o));
    if ((tid & 63) == 0) red[tid >> 6] = mx; __syncthreads(); mx = fmaxf(red[0], red[1]); __syncthreads();
    float sum = 0.f;
    for (int j = tid; j < 257; j += 128) { const float p = exp2f(sc[j] - mx); sc[j] = p; sum += p; }
#pragma unroll
    for (int o = 1; o < 64; o <<= 1) sum += __shfl_xor(sum, o);
    if ((tid & 63) == 0) red[2 + (tid >> 6)] = sum; __syncthreads();
    const float denom = red[2] + red[3] + exp2f(SINK2[h] - mx);
    const bf16* vr = Vt + (size_t)(kvh * 128 + tid) * MG + sbase; float o = 0.f;
    for (int j = 0; j < 257; ++j) { const int p = t - 128 + j; if (p >= 0 && p < L) o += sc[j] * bf2f(vr[p]); }
    HA[(size_t)m * 2304 + 1280 + h * 128 + tid] = f2bf(o / denom);
}
__global__ void ffn_gate(const bf16* __restrict__ UP, const float* __restrict__ w, const float* __restrict__ b, bf16* __restrict__ H, int L) {
    const size_t i = (size_t)blockIdx.x * blockDim.x + threadIdx.x; if (i >= (size_t)MG * DFF) return;
    const int m = (int)(i / DFF), j = (int)(i % DFF), t = m % L; float hv = b[j], hg = b[DFF + j];
#pragma unroll
    for (int tap = 0; tap < 3; ++tap) { const int tt = t + tap - 1; if (tt >= 0 && tt < L) { const bf16* r = UP + (size_t)(m + tap - 1) * DUP; hv += w[tap * DUP + j] * bf2f(r[j]); hg += w[tap * DUP + DFF + j] * bf2f(r[DFF + j]); } }
    H[i] = f2bf(gelu_tanh(hg) * hv);
}
}

extern "C" void kernel_launch(void* const* d_in, const int* in_sizes, int n_in, void* d_out, int out_size, void* d_ws, size_t ws_size, hipStream_t stream) {
    if (n_in != 27 || ws_size < WS_END || out_size != 3 * MG * D) { fprintf(stderr, "kernel_launch: unexpected sizes (n_in %d, ws %zu, out %d)\n", n_in, ws_size, out_size); return; }
    const float* const* in = (const float* const*)d_in;
    const float *x_prompt = in[0], *x_sample = in[1], *rel_table = in[2], *w_in = in[3], *b_in = in[4], *w_lconv = in[5], *b_lconv = in[6], *w_rga = in[7], *b_rga = in[8], *w_rgx = in[9], *b_rgx = in[10],
                *lam = in[11], *w_lout = in[12], *sink = in[13], *w_aout = in[14], *w_o = in[15], *b_o = in[16], *ln1g = in[17], *ln1b = in[18], *w_up = in[19], *b_up = in[20], *w_fconv = in[21], *b_fconv = in[22],
                *w_down = in[23], *b_down = in[24], *ln2g = in[25], *ln2b = in[26];
    char* ws = (char*)d_ws; float* out = (float*)d_out;
    bf16 *WinT = (bf16*)(ws + WS_WIN), *WupT = (bf16*)(ws + WS_WUP), *WdT = (bf16*)(ws + WS_WD), *WlaT = (bf16*)(ws + WS_WLA), *WoT = (bf16*)(ws + WS_WO), *RGW = (bf16*)(ws + WS_RGW);
    float *C8 = (float*)(ws + WS_TAB + TAB_C8), *BIAS2 = (float*)(ws + WS_TAB + TAB_BIAS2), *SINK2 = (float*)(ws + WS_TAB + TAB_SINK2);
    float *SUM = (float*)(ws + WS_SUM), *HIN = (float*)(ws + WS_HIN);
    bf16 *U = (bf16*)(ws + WS_A + A_U), *GG = (bf16*)(ws + WS_A + A_GG), *Q = (bf16*)(ws + WS_A + A_Q), *Kb = (bf16*)(ws + WS_A + A_K), *Vt = (bf16*)(ws + WS_A + A_VT), *SGL = (bf16*)(ws + WS_A + A_SGL), *SGA = (bf16*)(ws + WS_A + A_SGA);
    bf16 *UP = (bf16*)(ws + WS_A);
    bf16 *Sb = (bf16*)(ws + WS_B + B_S), *PF = (bf16*)(ws + WS_B + B_PF), *PB = (bf16*)(ws + WS_B + B_PB), *Z = (bf16*)(ws + WS_B + B_Z), *X1B = (bf16*)(ws + WS_B + B_X1B), *H = (bf16*)(ws + WS_B + B_H);
    bf16 *UC = (bf16*)(ws + WS_C), *HA = (bf16*)(ws + WS_C); float* X1 = (float*)(ws + WS_C);
    nv::transpose_w<<<2048, 256, 0, stream>>>(w_in, D, DIN, WinT, D, 0);
    nv::transpose_w<<<2048, 256, 0, stream>>>(w_up, D, DUP, WupT, D, 0);
    nv::transpose_w<<<2048, 256, 0, stream>>>(w_down, DFF, D, WdT, DFF, 0);
    nv::transpose_w<<<2048, 256, 0, stream>>>(w_lout, DRNN, D, WlaT, 2304, 0);
    nv::transpose_w<<<2048, 256, 0, stream>>>(w_aout, D, D, WlaT, 2304, 1280);
    nv::transpose_w<<<2048, 256, 0, stream>>>(w_o, D, D, WoT, D, 0);
    nv::transpose_rg<<<(2 * 8 * 2 * 160 * 160 + 255) / 256, 256, 0, stream>>>(w_rga, w_rgx, RGW);
    nv::tables<<<(8 * 511 + 255) / 256, 256, 0, stream>>>(lam, rel_table, sink, C8, BIAS2, SINK2);
    for (int g = 0; g < NG; ++g) {
        const float* xg = (g < 2) ? x_prompt + (size_t)g * MG * D : x_sample; float* og = out + (size_t)g * MG * D; bf16* XB = (bf16*)og;
        const int L = (g < 2) ? 4096 : 8192;
        nv::cvt_x<<<2048, 256, 0, stream>>>(xg, XB, (size_t)MG * D / 4);
        nv::gemm<nv::EpiProj><<<dim3(DIN / 128, MG / 128), 256, 0, stream>>>(XB, D, WinT, D, D, nv::EpiProj{b_in, U, GG, Q, Kb, Vt, SGL, SGA});
        nv::lru_conv<<<(MG * 1280 + 255) / 256, 256, 0, stream>>>(U, w_lconv, b_lconv, UC, L);
        nv::lru_chunk<<<(NCH * 1280 + 127) / 128, 128, 0, stream>>>(UC, RGW, b_rga, b_rgx, C8, Sb, PF, PB, SUM);
        nv::lru_carry<<<((MG / L) * 2560 + 255) / 256, 256, 0, stream>>>(SUM, HIN, MG / L, L / CH);
        nv::lru_final<<<(MG * 1280 + 255) / 256, 256, 0, stream>>>(Sb, PF, PB, HIN, GG, HA);
        nv::attn<<<dim3(MG, NHEAD), 128, 0, stream>>>(Q, Kb, Vt, BIAS2, SINK2, HA, L);
        nv::gemm<nv::EpiZ1><<<dim3(D / 128, MG / 128), 256, 0, stream>>>(HA, 2304, WlaT, 2304, DRNN, nv::EpiZ1{SGL, Z});
        nv::gemm<nv::EpiZ2><<<dim3(D / 128, MG / 128), 256, 0, stream>>>(HA + 1280, 2304, WlaT + 1280, 2304, D, nv::EpiZ2{SGA, Z});
        nv::gemm<nv::EpiRes><<<dim3(D / 128, MG / 128), 256, 0, stream>>>(Z, D, WoT, D, D, nv::EpiRes{xg, b_o, X1});
        nv::ln_rows<<<MG / 4, 256, 0, stream>>>(X1, ln1g, ln1b, X1B, MG);
        nv::gemm<nv::EpiUp><<<dim3(DUP / 128, MG / 128), 256, 0, stream>>>(X1B, D, WupT, D, D, nv::EpiUp{b_up, UP});
        nv::ffn_gate<<<(int)(((size_t)MG * DFF + 255) / 256), 256, 0, stream>>>(UP, w_fconv, b_fconv, H, L);
        nv::gemm<nv::EpiRes><<<dim3(D / 128, MG / 128), 256, 0, stream>>>(H, DFF, WdT, DFF, DFF, nv::EpiRes{X1, b_down, og});
        nv::ln_rows<<<MG / 4, 256, 0, stream>>>(og, ln2g, ln2b, nullptr, MG);
    }
}
```
